# Optimizing an MI355X kernel written in HIP

```python
import jax, jax.numpy as jnp
from jax import lax
import numpy as np

D_MODEL = 2048
BATCH = 16
SEQ = 2048
DEPTH = 4

D_FF = 4 * D_MODEL
CONV_WIDTH = 3
N_HEADS = 16
QK_HEAD_DIM = 128
V_HEAD_DIM = 128
Q_LORA = 512
KV_LORA = 256
IDX_HEADS = 16
IDX_DIM = 64
TOPK_MAX = 256
Q_BLOCK = 64
ATTN_SCALE = QK_HEAD_DIM ** -0.5
IN_COLS = Q_LORA + KV_LORA + IDX_DIM + IDX_HEADS
EPS = 1e-6
N_CONV = (DEPTH + 1) // 2
N_ATTN = DEPTH // 2

kernel_name = "hybrid_shortconv_dsa_sqrelu"


def rmsnorm(x, g):
    xf = x.astype(jnp.float32)
    y = xf * lax.rsqrt(jnp.mean(xf * xf, axis=-1, keepdims=True) + EPS)
    return (y * g.astype(jnp.float32)).astype(x.dtype)


def layernorm(x, g, b):
    xf = x.astype(jnp.float32)
    mu = jnp.mean(xf, axis=-1, keepdims=True)
    var = jnp.mean(jnp.square(xf - mu), axis=-1, keepdims=True)
    y = (xf - mu) * lax.rsqrt(var + EPS)
    return y * g.astype(jnp.float32) + b.astype(jnp.float32)


def sq_relu_mlp(h, w1, w2):
    return jnp.square(jax.nn.relu(h @ w1)) @ w2


def short_conv_mixer(h, w_in, conv_w, w_out):
    bg, cg, xt = jnp.split(h @ w_in, 3, axis=-1)
    z = cg * xt
    zp = jnp.pad(z, ((0, 0), (CONV_WIDTH - 1, 0), (0, 0)))
    s = z.shape[1]
    zc = conv_w[0] * zp[:, 0:s] + conv_w[1] * zp[:, 1:s + 1] + conv_w[2] * zp[:, 2:s + 2]
    return (bg * zc) @ w_out


def dsa_mixer(h, w_in, q_g, kv_g, w_uq, w_uk, w_uv, w_qidx, ln_g, ln_b, w_out):
    b, s, _ = h.shape
    topk = min(TOPK_MAX, s // 4)
    proj = h @ w_in
    c_q, c_kv, k_idx, w_idx = jnp.split(
        proj, [Q_LORA, Q_LORA + KV_LORA, Q_LORA + KV_LORA + IDX_DIM], axis=-1)
    c_q = rmsnorm(c_q, q_g)
    c_kv = rmsnorm(c_kv, kv_g)
    k_idx = layernorm(k_idx, ln_g, ln_b)
    w_idx = w_idx.astype(jnp.float32) * (IDX_HEADS ** -0.5 * IDX_DIM ** -0.5)
    nb = s // Q_BLOCK
    key_pos = jnp.arange(s, dtype=jnp.int32)

    def to_blocks(a):
        return a.reshape(b, nb, Q_BLOCK, *a.shape[2:]).swapaxes(0, 1)

    def block(args):
        cq, wi, t = args
        q = jnp.einsum('bqr,rhd->bqhd', cq, w_uq)
        q_lat = jnp.einsum('bqhd,hdc->bqhc', q, w_uk)
        q_idx = jnp.einsum('bqr,rhe->bqhe', cq, w_qidx).astype(jnp.float32)
        rel = jax.nn.relu(jnp.einsum('bqhe,bse->bqhs', q_idx, k_idx))
        score = jnp.einsum('bqhs,bqh->bqs', rel, wi)
        causal = key_pos[None, :] <= t[:, None]
        score = jnp.where(causal[None], score, -jnp.inf)
        _, idx = lax.top_k(score, topk)
        kv_sel = jax.vmap(lambda c, i: c[i])(c_kv, idx)
        logits = jnp.einsum('bqhc,bqkc->bqhk', q_lat, kv_sel).astype(jnp.float32) * ATTN_SCALE
        valid = (idx <= t[None, :, None])[:, :, None, :]
        p = jax.nn.softmax(jnp.where(valid, logits, -jnp.inf), axis=-1).astype(h.dtype)
        o_lat = jnp.einsum('bqhk,bqkc->bqhc', p, kv_sel)
        o = jnp.einsum('bqhc,hcv->bqhv', o_lat, w_uv).reshape(b, Q_BLOCK, N_HEADS * V_HEAD_DIM)
        return o @ w_out

    out = lax.map(block, (to_blocks(c_q), to_blocks(w_idx), key_pos.reshape(nb, Q_BLOCK)))
    return out.swapaxes(0, 1).reshape(b, s, -1)


def setup_inputs(seed: int = 0) -> dict:
    key = jax.random.key(seed)
    ks = jax.random.split(key, 20)
    f32 = jnp.float32

    def nrm(k, shape, fan_in):
        return jax.random.normal(k, shape, f32) * (fan_in ** -0.5)

    def gain(k, shape):
        return 1.0 + 0.02 * jax.random.normal(k, shape, f32)

    return {
        "x": jax.random.normal(ks[0], (BATCH, SEQ, D_MODEL), f32),
        "norm_mix": gain(ks[1], (DEPTH, D_MODEL)),
        "norm_mlp": gain(ks[2], (DEPTH, D_MODEL)),
        "mlp_w1": nrm(ks[3], (DEPTH, D_MODEL, D_FF), D_MODEL),
        "mlp_w2": nrm(ks[4], (DEPTH, D_FF, D_MODEL), D_FF),
        "conv_in": nrm(ks[5], (N_CONV, D_MODEL, 3 * D_MODEL), D_MODEL),
        "conv_w": nrm(ks[6], (N_CONV, CONV_WIDTH, D_MODEL), CONV_WIDTH),
        "conv_out": nrm(ks[7], (N_CONV, D_MODEL, D_MODEL), D_MODEL),
        "attn_in": nrm(ks[8], (N_ATTN, D_MODEL, IN_COLS), D_MODEL),
        "q_norm": gain(ks[9], (N_ATTN, Q_LORA)),
        "kv_norm": gain(ks[10], (N_ATTN, KV_LORA)),
        "w_uq": nrm(ks[11], (N_ATTN, Q_LORA, N_HEADS, QK_HEAD_DIM), Q_LORA),
        "w_uk": nrm(ks[12], (N_ATTN, N_HEADS, QK_HEAD_DIM, KV_LORA), QK_HEAD_DIM),
        "w_uv": nrm(ks[13], (N_ATTN, N_HEADS, KV_LORA, V_HEAD_DIM), KV_LORA),
        "w_qidx": nrm(ks[14], (N_ATTN, Q_LORA, IDX_HEADS, IDX_DIM), Q_LORA),
        "kidx_ln_g": gain(ks[15], (N_ATTN, IDX_DIM)),
        "kidx_ln_b": 0.02 * jax.random.normal(ks[16], (N_ATTN, IDX_DIM), f32),
        "attn_out": nrm(ks[17], (N_ATTN, N_HEADS * V_HEAD_DIM, D_MODEL), N_HEADS * V_HEAD_DIM),
        "final_norm": gain(ks[18], (D_MODEL,)),
    }


def reference(x, norm_mix, norm_mlp, mlp_w1, mlp_w2, conv_in, conv_w, conv_out,
              attn_in, q_norm, kv_norm, w_uq, w_uk, w_uv, w_qidx, kidx_ln_g, kidx_ln_b,
              attn_out, final_norm):
    h = x
    for i in range(DEPTH):
        j = i // 2
        hn = rmsnorm(h, norm_mix[i])
        if i % 2 == 0:
            h = h + short_conv_mixer(hn, conv_in[j], conv_w[j], conv_out[j])
        else:
            h = h + dsa_mixer(hn, attn_in[j], q_norm[j], kv_norm[j], w_uq[j], w_uk[j],
                              w_uv[j], w_qidx[j], kidx_ln_g[j], kidx_ln_b[j], attn_out[j])
        h = h + sq_relu_mlp(rmsnorm(h, norm_mlp[i]), mlp_w1[i], mlp_w2[i])
    return rmsnorm(h, final_norm)
```

```cpp
#include <hip/hip_runtime.h>
#include <hip/hip_bf16.h>
#include <stdint.h>

typedef __attribute__((ext_vector_type(8))) short bf16x8;
typedef __attribute__((ext_vector_type(4))) float f32x4;
typedef unsigned short bf16_t;

#define T_ 32768
#define D_ 2048
#define FF_ 8192
#define MiB (1024l * 1024l)

struct Params { const float* in[19]; float* out; char* ws; };

__device__ __forceinline__ bf16_t f2bf(float f) {
  unsigned u = __float_as_uint(f);
  u += 0x7fffu + ((u >> 16) & 1u);
  return (bf16_t)(u >> 16);
}
__device__ __forceinline__ unsigned pack2(float a, float b) { return (unsigned)f2bf(a) | ((unsigned)f2bf(b) << 16); }
__device__ __forceinline__ float bflo(unsigned u) { return __uint_as_float(u << 16); }
__device__ __forceinline__ float bfhi(unsigned u) { return __uint_as_float(u & 0xffff0000u); }
__device__ __forceinline__ float wave_sum(float v) {
#pragma unroll
  for (int o = 32; o; o >>= 1) v += __shfl_xor(v, o);
  return v;
}
#define WSYNC() do { __builtin_amdgcn_fence(__ATOMIC_SEQ_CST, "workgroup"); __builtin_amdgcn_wave_barrier(); } while (0)

__device__ __forceinline__ void grid_bar(unsigned* cnt, unsigned& epoch) {
  __builtin_amdgcn_fence(__ATOMIC_RELEASE, "agent");
  __syncthreads();
  epoch++;
  if (threadIdx.x == 0) {
    unsigned target = epoch * gridDim.x;
    __hip_atomic_fetch_add(cnt, 1u, __ATOMIC_RELEASE, __HIP_MEMORY_SCOPE_AGENT);
    unsigned sp = 0;
    while (__hip_atomic_load(cnt, __ATOMIC_RELAXED, __HIP_MEMORY_SCOPE_AGENT) < target) {
      __builtin_amdgcn_s_sleep(2);
      if (++sp > (1u << 26)) break;
    }
  }
  __syncthreads();
  __builtin_amdgcn_fence(__ATOMIC_ACQUIRE, "agent");
}

__device__ void transpose_phase(const float* __restrict__ src, bf16_t* __restrict__ dst, int K, int N, int Npad, int batch, char* smem) {
  float* t = (float*)smem;
  const int tid = threadIdx.x;
  const int tk = K / 64, tn = Npad / 64;
  const int total = batch * tk * tn;
  for (int id = blockIdx.x; id < total; id += gridDim.x) {
    int bb = id / (tk * tn); int r = id % (tk * tn); int kt = r / tn, nt = r % tn;
    const float* s = src + (long)bb * K * N; bf16_t* d = dst + (long)bb * Npad * K;
    int k0 = kt * 64, n0 = nt * 64;
    __syncthreads();
#pragma unroll
    for (int i = 0; i < 16; ++i) {
      int kk = i * 4 + (tid >> 6), c = tid & 63, n = n0 + c;
      t[kk * 65 + c] = (n < N) ? s[(long)(k0 + kk) * N + n] : 0.f;
    }
    __syncthreads();
#pragma unroll
    for (int i = 0; i < 16; ++i) {
      int nn = i * 4 + (tid >> 6), kk = tid & 63;
      d[(long)(n0 + nn) * K + k0 + kk] = f2bf(t[kk * 65 + nn]);
    }
  }
}

__device__ __forceinline__ void gemm_phase(const int EPI, const bf16_t* A, int lda, long a_bs, const bf16_t* Bt, int ldb, long b_bs,
                           void* Cv, int ldc, long c_bs, int N, int K, int batch, char* smem) {
  bf16_t* sA = (bf16_t*)smem;
  bf16_t* sB = sA + 128 * 40;
  const int tid = threadIdx.x, lane = tid & 63, wave = tid >> 6;
  const int wm = (wave >> 1) * 64, wn = (wave & 1) * 64;
  const int tn = N / 128;
  const int per = 256 * tn;
  const int total = per * batch;
  const int lr = lane & 15, lg = lane >> 4;
  for (int id = blockIdx.x; id < total; id += gridDim.x) {
    int bb = id / per; int r = id % per;
    int grp = r / (16 * tn); int rem = r % (16 * tn);
    int m0 = (grp * 16 + (rem & 15)) * 128, n0 = (rem >> 4) * 128;
    const bf16_t* Ab = A + bb * a_bs + (long)m0 * lda;
    const bf16_t* Bb = Bt + bb * b_bs + (long)n0 * ldb;
    f32x4 acc[4][4];
#pragma unroll
    for (int i = 0; i < 4; ++i)
#pragma unroll
      for (int j = 0; j < 4; ++j) acc[i][j] = (f32x4){0.f, 0.f, 0.f, 0.f};
    const int r0 = tid >> 2, kc = (tid & 3) * 8;
    const bf16_t* ga0 = Ab + (long)r0 * lda + kc;
    const bf16_t* ga1 = Ab + (long)(r0 + 64) * lda + kc;
    const bf16_t* gb0 = Bb + (long)r0 * ldb + kc;
    const bf16_t* gb1 = Bb + (long)(r0 + 64) * ldb + kc;
    uint4 ra0 = *(const uint4*)ga0, ra1 = *(const uint4*)ga1, rb0 = *(const uint4*)gb0, rb1 = *(const uint4*)gb1;
    for (int k0 = 0; k0 < K; k0 += 32) {
      __syncthreads();
      *(uint4*)(sA + r0 * 40 + kc) = ra0;
      *(uint4*)(sA + (r0 + 64) * 40 + kc) = ra1;
      *(uint4*)(sB + r0 * 40 + kc) = rb0;
      *(uint4*)(sB + (r0 + 64) * 40 + kc) = rb1;
      __syncthreads();
      if (k0 + 32 < K) {
        ra0 = *(const uint4*)(ga0 + k0 + 32); ra1 = *(const uint4*)(ga1 + k0 + 32);
        rb0 = *(const uint4*)(gb0 + k0 + 32); rb1 = *(const uint4*)(gb1 + k0 + 32);
      }
      bf16x8 fa[4], fb[4];
#pragma unroll
      for (int i = 0; i < 4; ++i) fa[i] = *(const bf16x8*)(sA + (wm + i * 16 + lr) * 40 + lg * 8);
#pragma unroll
      for (int j = 0; j < 4; ++j) fb[j] = *(const bf16x8*)(sB + (wn + j * 16 + lr) * 40 + lg * 8);
#pragma unroll
      for (int i = 0; i < 4; ++i)
#pragma unroll
        for (int j = 0; j < 4; ++j) acc[i][j] = __builtin_amdgcn_mfma_f32_16x16x32_bf16(fa[i], fb[j], acc[i][j], 0, 0, 0);
    }
#pragma unroll
    for (int i = 0; i < 4; ++i)
#pragma unroll
      for (int j = 0; j < 4; ++j)
#pragma unroll
        for (int rr = 0; rr < 4; ++rr) {
          long row = m0 + wm + i * 16 + lg * 4 + rr; int col = n0 + wn + j * 16 + lr;
          float v = acc[i][j][rr];
          long off = bb * c_bs + row * ldc + col;
          if (EPI == 0) ((bf16_t*)Cv)[off] = f2bf(v);
          else if (EPI == 1) { float x = fmaxf(v, 0.f); ((bf16_t*)Cv)[off] = f2bf(x * x); }
          else if (EPI == 2) ((float*)Cv)[off] += v;
          else ((float*)Cv)[off] = v;
        }
  }
}

__device__ void rms_phase(const float* src, const float* __restrict__ g, bf16_t* dstb, float* dstf, int mode) {
  const int lane = threadIdx.x & 63;
  const int gw = blockIdx.x * 4 + (threadIdx.x >> 6), nw = gridDim.x * 4;
  for (int row = gw; row < T_; row += nw) {
    const float4* p = (const float4*)(src + (long)row * D_);
    float4 v[8]; float ss = 0.f;
#pragma unroll
    for (int i = 0; i < 8; ++i) { v[i] = p[lane + 64 * i]; ss += v[i].x * v[i].x + v[i].y * v[i].y + v[i].z * v[i].z + v[i].w * v[i].w; }
    ss = wave_sum(ss);
    float rs = rsqrtf(ss * (1.f / D_) + 1e-6f);
#pragma unroll
    for (int i = 0; i < 8; ++i) {
      float4 gg = ((const float4*)g)[lane + 64 * i];
      float4 y; y.x = v[i].x * rs * gg.x; y.y = v[i].y * rs * gg.y; y.z = v[i].z * rs * gg.z; y.w = v[i].w * rs * gg.w;
      if (mode == 2) ((float4*)(dstf + (long)row * D_))[lane + 64 * i] = y;
      else {
        uint2 o; o.x = pack2(y.x, y.y); o.y = pack2(y.z, y.w);
        *(uint2*)(dstb + (long)row * D_ + (lane + 64 * i) * 4) = o;
        if (mode == 1) ((float4*)(dstf + (long)row * D_))[lane + 64 * i] = v[i];
      }
    }
  }
}

__device__ __forceinline__ void mulz(uint4 c, uint4 x, float* z) {
  z[0] = bflo(c.x) * bflo(x.x); z[1] = bfhi(c.x) * bfhi(x.x);
  z[2] = bflo(c.y) * bflo(x.y); z[3] = bfhi(c.y) * bfhi(x.y);
  z[4] = bflo(c.z) * bflo(x.z); z[5] = bfhi(c.z) * bfhi(x.z);
  z[6] = bflo(c.w) * bflo(x.w); z[7] = bfhi(c.w) * bfhi(x.w);
}

__device__ void conv_phase(const bf16_t* proj, const float* __restrict__ cw, bf16_t* u) {
  const long total = (long)T_ * 256;
  for (long id = (long)blockIdx.x * 256 + threadIdx.x; id < total; id += (long)gridDim.x * 256) {
    int tok = (int)(id >> 8); int d0 = (int)(id & 255) * 8; int s = tok & 2047;
    const bf16_t* row = proj + (long)tok * 6144 + d0;
    uint4 bg = *(const uint4*)row;
    float z0[8], z1[8], z2[8];
    mulz(*(const uint4*)(row + 2048), *(const uint4*)(row + 4096), z0);
    if (s >= 1) mulz(*(const uint4*)(row - 6144 + 2048), *(const uint4*)(row - 6144 + 4096), z1);
    else {
#pragma unroll
      for (int i = 0; i < 8; ++i) z1[i] = 0.f;
    }
    if (s >= 2) mulz(*(const uint4*)(row - 12288 + 2048), *(const uint4*)(row - 12288 + 4096), z2);
    else {
#pragma unroll
      for (int i = 0; i < 8; ++i) z2[i] = 0.f;
    }
    float b[8];
    b[0] = bflo(bg.x); b[1] = bfhi(bg.x); b[2] = bflo(bg.y); b[3] = bfhi(bg.y);
    b[4] = bflo(bg.z); b[5] = bfhi(bg.z); b[6] = bflo(bg.w); b[7] = bfhi(bg.w);
    float o[8];
#pragma unroll
    for (int i = 0; i < 8; ++i)
      o[i] = b[i] * (cw[d0 + i] * z2[i] + cw[2048 + d0 + i] * z1[i] + cw[4096 + d0 + i] * z0[i]);
    uint4 ov; ov.x = pack2(o[0], o[1]); ov.y = pack2(o[2], o[3]); ov.z = pack2(o[4], o[5]); ov.w = pack2(o[6], o[7]);
    *(uint4*)(u + (long)tok * D_ + d0) = ov;
  }
}

__device__ void attn_norm_phase(const float* proj, const float* __restrict__ qg, const float* __restrict__ kvg,
                                const float* __restrict__ lng, const float* __restrict__ lnb,
                                bf16_t* cq, bf16_t* ckv, float* kidx, float* widx) {
  const int lane = threadIdx.x & 63;
  const int gw = blockIdx.x * 4 + (threadIdx.x >> 6), nw = gridDim.x * 4;
  for (int tok = gw; tok < T_; tok += nw) {
    const float* r = proj + (long)tok * 896;
    float a[8]; float ss = 0.f;
#pragma unroll
    for (int i = 0; i < 8; ++i) { a[i] = r[lane + 64 * i]; ss += a[i] * a[i]; }
    ss = wave_sum(ss); float rs = rsqrtf(ss * (1.f / 512.f) + 1e-6f);
#pragma unroll
    for (int i = 0; i < 8; ++i) cq[(long)tok * 512 + lane + 64 * i] = f2bf(a[i] * rs * qg[lane + 64 * i]);
    float c[4]; ss = 0.f;
#pragma unroll
    for (int i = 0; i < 4; ++i) { c[i] = r[512 + lane + 64 * i]; ss += c[i] * c[i]; }
    ss = wave_sum(ss); rs = rsqrtf(ss * (1.f / 256.f) + 1e-6f);
#pragma unroll
    for (int i = 0; i < 4; ++i) ckv[(long)tok * 256 + lane + 64 * i] = f2bf(c[i] * rs * kvg[lane + 64 * i]);
    float k = r[768 + lane];
    float mu = wave_sum(k) * (1.f / 64.f); float dk = k - mu;
    float var = wave_sum(dk * dk) * (1.f / 64.f);
    kidx[(long)tok * 64 + lane] = dk * rsqrtf(var + 1e-6f) * lng[lane] + lnb[lane];
    if (lane < 16) widx[(long)tok * 16 + lane] = r[832 + lane] * (1.f / 32.f);
  }
}

__device__ __forceinline__ unsigned okey(float f) {
  unsigned u = __float_as_uint(f);
  return (u & 0x80000000u) ? ~u : (u | 0x80000000u);
}

__device__ void attn_phase(const float* qidx, const float* kidx, const float* widx, const bf16_t* ckv, bf16_t* qlat, char* smem) {
  const int lane = threadIdx.x & 63, w = threadIdx.x >> 6;
  char* base = smem + w * 13312;
  unsigned* keys = (unsigned*)base;
  float* qs = (float*)(base + 8192);
  unsigned short* list = (unsigned short*)(base + 12288);
  bf16_t* P = (bf16_t*)base;
  const int gw = blockIdx.x * 4 + w, nw = gridDim.x * 4;
  const int lr = lane & 15, lg4 = lane >> 4;
  const unsigned long long ltm = (1ull << lane) - 1ull;
  for (int q = gw; q < T_; q += nw) {
    const int b = q >> 11; const int t = ((q & 2047) + b * 131) & 2047;
    const int tok = b * 2048 + t;
    WSYNC();
#pragma unroll
    for (int i = 0; i < 4; ++i) ((float4*)qs)[lane + 64 * i] = ((const float4*)(qidx + (long)tok * 1024))[lane + 64 * i];
    WSYNC();
    const int ntile = (t >> 6) + 1;
    const float* kb = kidx + (long)b * 2048 * 64;
    const float* wrow = widx + (long)tok * 16;
#pragma unroll 1
    for (int tile = 0; tile < ntile; ++tile) {
      int s = tile * 64 + lane;
      const float4* kr = (const float4*)(kb + (long)s * 64);
      float4 k[16];
#pragma unroll
      for (int i = 0; i < 16; ++i) k[i] = kr[i];
      float score = 0.f;
#pragma unroll 1
      for (int h = 0; h < 16; ++h) {
        const float4* qh = (const float4*)(qs + h * 64);
        float d = 0.f;
#pragma unroll
        for (int i = 0; i < 16; ++i) { float4 qq = qh[i]; d += qq.x * k[i].x + qq.y * k[i].y + qq.z * k[i].z + qq.w * k[i].w; }
        score += wrow[h] * fmaxf(d, 0.f);
      }
      keys[s] = (s <= t) ? okey(score) : 0u;
    }
    WSYNC();
    int n;
    if (t < 256) {
      n = t + 1;
      for (int j = lane; j < n; j += 64) list[j] = (unsigned short)j;
    } else {
      n = 256;
      unsigned Tm = 0u;
#pragma unroll 1
      for (int bit = 31; bit >= 0; --bit) {
        unsigned cand = Tm | (1u << bit); int cnt = 0;
        for (int tile = 0; tile < ntile; ++tile) cnt += __popcll(__ballot(keys[tile * 64 + lane] >= cand));
        if (cnt >= 256) Tm = cand;
      }
      int ngt = 0;
      for (int tile = 0; tile < ntile; ++tile) ngt += __popcll(__ballot(keys[tile * 64 + lane] > Tm));
      int eqb = 256 - ngt, eqs = 0, cnt = 0;
      for (int tile = 0; tile < ntile; ++tile) {
        int s = tile * 64 + lane;
        unsigned kx = keys[s]; bool gt = kx > Tm, eq = kx == Tm;
        unsigned long long em = __ballot(eq);
        bool sel = gt || (eq && (eqs + __popcll(em & ltm)) < eqb);
        unsigned long long sm = __ballot(sel);
        if (sel) list[cnt + __popcll(sm & ltm)] = (unsigned short)s;
        cnt += __popcll(sm); eqs += __popcll(em);
      }
    }
    WSYNC();
    bf16_t* qrow = qlat + (long)tok * 4096;
    bf16x8 aq[8];
#pragma unroll
    for (int ks = 0; ks < 8; ++ks) aq[ks] = *(const bf16x8*)(qrow + lr * 256 + ks * 32 + lg4 * 8);
    const bf16_t* cb = ckv + (long)b * 2048 * 256;
    f32x4 lgt[16];
    const float scale = 0.08838834764831845f;
#pragma unroll
    for (int jt = 0; jt < 16; ++jt) {
      if (jt * 16 < n) {
        int j = jt * 16 + lr; int idx = list[j < n ? j : 0];
        const bf16_t* kr = cb + (long)idx * 256 + lg4 * 8;
        f32x4 acc = (f32x4){0.f, 0.f, 0.f, 0.f};
#pragma unroll
        for (int ks = 0; ks < 8; ++ks) acc = __builtin_amdgcn_mfma_f32_16x16x32_bf16(aq[ks], *(const bf16x8*)(kr + ks * 32), acc, 0, 0, 0);
#pragma unroll
        for (int r = 0; r < 4; ++r) lgt[jt][r] = (j < n) ? acc[r] * scale : -INFINITY;
      } else {
        lgt[jt] = (f32x4){-INFINITY, -INFINITY, -INFINITY, -INFINITY};
      }
    }
    float mx[4], sm4[4];
#pragma unroll
    for (int r = 0; r < 4; ++r) {
      float m = lgt[0][r];
#pragma unroll
      for (int jt = 1; jt < 16; ++jt) m = fmaxf(m, lgt[jt][r]);
      m = fmaxf(m, __shfl_xor(m, 1)); m = fmaxf(m, __shfl_xor(m, 2)); m = fmaxf(m, __shfl_xor(m, 4)); m = fmaxf(m, __shfl_xor(m, 8));
      mx[r] = m;
      float s = 0.f;
#pragma unroll
      for (int jt = 0; jt < 16; ++jt) { float e = __expf(lgt[jt][r] - m); lgt[jt][r] = e; s += e; }
      s += __shfl_xor(s, 1); s += __shfl_xor(s, 2); s += __shfl_xor(s, 4); s += __shfl_xor(s, 8);
      sm4[r] = 1.f / s;
    }
    WSYNC();
#pragma unroll
    for (int jt = 0; jt < 16; ++jt) {
      if (jt * 16 < n) {
        int j = jt * 16 + lr;
        uint2 pv; pv.x = pack2(lgt[jt][0] * sm4[0], lgt[jt][1] * sm4[1]); pv.y = pack2(lgt[jt][2] * sm4[2], lgt[jt][3] * sm4[3]);
        *(uint2*)(P + j * 16 + lg4 * 4) = pv;
      }
    }
    WSYNC();
    float o[16][4];
#pragma unroll
    for (int h = 0; h < 16; ++h) { o[h][0] = 0.f; o[h][1] = 0.f; o[h][2] = 0.f; o[h][3] = 0.f; }
#pragma unroll 2
    for (int j = 0; j < n; ++j) {
      int idx = list[j];
      uint2 vv = *(const uint2*)(cb + (long)idx * 256 + lane * 4);
      float v0 = bflo(vv.x), v1 = bfhi(vv.x), v2 = bflo(vv.y), v3 = bfhi(vv.y);
      uint4 p0 = *(const uint4*)(P + j * 16), p1 = *(const uint4*)(P + j * 16 + 8);
      unsigned pw[8] = {p0.x, p0.y, p0.z, p0.w, p1.x, p1.y, p1.z, p1.w};
#pragma unroll
      for (int hh = 0; hh < 8; ++hh) {
        float pa = bflo(pw[hh]), pb = bfhi(pw[hh]);
        o[2 * hh][0] += pa * v0; o[2 * hh][1] += pa * v1; o[2 * hh][2] += pa * v2; o[2 * hh][3] += pa * v3;
        o[2 * hh + 1][0] += pb * v0; o[2 * hh + 1][1] += pb * v1; o[2 * hh + 1][2] += pb * v2; o[2 * hh + 1][3] += pb * v3;
      }
    }
#pragma unroll
    for (int h = 0; h < 16; ++h) {
      uint2 ov; ov.x = pack2(o[h][0], o[h][1]); ov.y = pack2(o[h][2], o[h][3]);
      *(uint2*)(qrow + h * 256 + lane * 4) = ov;
    }
  }
}

__global__ __launch_bounds__(256) void mega_kernel(Params p) {
  __shared__ __attribute__((aligned(16))) char smem[53248];
  unsigned epoch = 0; unsigned* bar = (unsigned*)p.ws;
  float* h = p.out;
  bf16_t* HN = (bf16_t*)(p.ws + 4096);
  char* BIGc = p.ws + 4096 + 128 * MiB;
  bf16_t* BIG = (bf16_t*)BIGc;
  bf16_t* W1T = (bf16_t*)(BIGc + 512 * MiB);
  bf16_t* W2T = W1T + 16 * MiB;
  bf16_t* WM = W2T + 16 * MiB;
  char* SM = (char*)(WM + 16 * MiB);
  bf16_t* CQ = (bf16_t*)SM;
  bf16_t* CKV = (bf16_t*)(SM + 32 * MiB);
  float* KIDX = (float*)(SM + 48 * MiB);
  float* WIDX = (float*)(SM + 56 * MiB);
  bf16_t* inT = WM; bf16_t* uqT = WM + 1835008; bf16_t* qiT = WM + 2883584; bf16_t* ukT = WM + 3407872;
  bf16_t* uvT = WM + 3932160; bf16_t* aoT = WM + 4456448; bf16_t* coT = WM + 12582912;
  float* PROJ = (float*)BIGc;
  float* QIDX = (float*)(BIGc + 256 * MiB);

#pragma unroll 1
  for (int L = 0; L <= 4; ++L) {
    const int j = L >> 1;
    const bool at = (L & 1) != 0;
#pragma unroll 1
    for (int step = 0; step < 12; ++step) {
      int type = 5;
      int epi = 0; const bf16_t* gA = HN; int lda = D_; long abs_ = 0; const bf16_t* gB = inT; int ldb = D_; long bbs = 0;
      void* gC = BIG; int ldc = D_; long cbs = 0; int gN = D_, gK = D_, gbatch = 1;
      const float* rsrc = h; const float* rg = p.in[18]; int rmode = 2;
      if (L == 4) { if (step == 0) type = 0; }
      else if (step == 0) { type = 0; rsrc = (L == 0) ? p.in[0] : h; rg = p.in[1] + L * D_; rmode = (L == 0) ? 1 : 0; }
      else if (step == 1) { type = 1; if (!at) { epi = 0; gC = BIG; ldc = 6144; gN = 6144; } else { epi = 3; gC = PROJ; ldc = 896; gN = 896; } }
      else if (step == 2) { type = at ? 3 : 2; }
      else if (step == 3) { if (at) { type = 1; epi = 0; gA = CQ; lda = 512; gB = uqT; ldb = 512; gC = HN; ldc = D_; gN = 2048; gK = 512; } }
      else if (step == 4) { if (at) { type = 1; epi = 3; gA = CQ; lda = 512; gB = qiT; ldb = 512; gC = QIDX; ldc = 1024; gN = 1024; gK = 512; } }
      else if (step == 5) { if (at) { type = 1; epi = 0; gA = HN; lda = D_; abs_ = 128; gB = ukT; ldb = 128; bbs = 256 * 128; gC = BIG; ldc = 4096; cbs = 256; gN = 256; gK = 128; gbatch = 16; } }
      else if (step == 6) { if (at) type = 4; }
      else if (step == 7) { if (at) { type = 1; epi = 0; gA = BIG; lda = 4096; abs_ = 256; gB = uvT; ldb = 256; bbs = 128 * 256; gC = HN; ldc = D_; cbs = 128; gN = 128; gK = 256; gbatch = 16; } }
      else if (step == 8) { type = 1; epi = 2; gB = at ? aoT : coT; gC = h; }
      else if (step == 9) { type = 0; rsrc = h; rg = p.in[2] + L * D_; rmode = 0; }
      else if (step == 10) { type = 1; epi = 1; gB = W1T; gC = BIG; ldc = FF_; gN = FF_; }
      else { type = 1; epi = 2; gA = BIG; lda = FF_; gB = W2T; ldb = FF_; gC = h; gK = FF_; }
      if (type == 5) continue;
      if (type == 0) {
        rms_phase(rsrc, rg, HN, h, rmode);
        if (step == 0 && L < 4) {
#pragma unroll 1
          for (int ti = 0; ti < 8; ++ti) {
            const float* ts = nullptr; bf16_t* td = nullptr; int tK = 0, tN = 0, tNp = 0, tb = 1;
            if (ti == 0) { ts = p.in[3] + (long)L * D_ * FF_; td = W1T; tK = D_; tN = FF_; tNp = FF_; }
            else if (ti == 1) { ts = p.in[4] + (long)L * D_ * FF_; td = W2T; tK = FF_; tN = D_; tNp = D_; }
            else if (!at) {
              if (ti == 2) { ts = p.in[5] + (long)j * D_ * 6144; td = inT; tK = D_; tN = 6144; tNp = 6144; }
              else if (ti == 3) { ts = p.in[7] + (long)j * D_ * D_; td = coT; tK = D_; tN = D_; tNp = D_; }
            } else {
              if (ti == 2) { ts = p.in[8] + (long)j * D_ * 848; td = inT; tK = D_; tN = 848; tNp = 896; }
              else if (ti == 3) { ts = p.in[11] + (long)j * 512 * 2048; td = uqT; tK = 512; tN = 2048; tNp = 2048; }
              else if (ti == 4) { ts = p.in[14] + (long)j * 512 * 1024; td = qiT; tK = 512; tN = 1024; tNp = 1024; }
              else if (ti == 5) { ts = p.in[12] + (long)j * 16 * 128 * 256; td = ukT; tK = 128; tN = 256; tNp = 256; tb = 16; }
              else if (ti == 6) { ts = p.in[13] + (long)j * 16 * 256 * 128; td = uvT; tK = 256; tN = 128; tNp = 128; tb = 16; }
              else { ts = p.in[17] + (long)j * D_ * D_; td = aoT; tK = D_; tN = D_; tNp = D_; }
            }
            if (ts != nullptr) transpose_phase(ts, td, tK, tN, tNp, tb, smem);
          }
        }
      } else if (type == 1) {
        gemm_phase(epi, gA, lda, abs_, gB, ldb, bbs, gC, ldc, cbs, gN, gK, gbatch, smem);
      } else if (type == 2) {
        conv_phase(BIG, p.in[6] + (long)j * 3 * D_, HN);
      } else if (type == 3) {
        attn_norm_phase(PROJ, p.in[9] + j * 512, p.in[10] + j * 256, p.in[15] + j * 64, p.in[16] + j * 64, CQ, CKV, KIDX, WIDX);
      } else {
        attn_phase(QIDX, KIDX, WIDX, CKV, BIG, smem);
      }
      if (L < 4) grid_bar(bar, epoch);
    }
  }
}

extern "C" void kernel_launch(void* const* d_in, const int* in_sizes, int n_in,
                              void* d_out, int out_size, void* d_ws, size_t ws_size,
                              hipStream_t stream) {
  Params p{};
  for (int i = 0; i < 19; ++i) p.in[i] = (const float*)d_in[i];
  p.out = (float*)d_out; p.ws = (char*)d_ws;
  hipMemsetAsync(d_ws, 0, 4096, stream);
  int occ = 0;
  hipOccupancyMaxActiveBlocksPerMultiprocessor(&occ, mega_kernel, 256, 0);
  int dev = 0; hipGetDevice(&dev);
  int ncu = 256; hipDeviceGetAttribute(&ncu, hipDeviceAttributeMultiprocessorCount, dev);
  int per = occ < 1 ? 1 : (occ > 2 ? 2 : occ);
  mega_kernel<<<dim3(ncu * per), dim3(256), 0, stream>>>(p);
}
```

```cpp
#include <hip/hip_runtime.h>
#include <hip/hip_bf16.h>
#include <stdint.h>

typedef __attribute__((ext_vector_type(8))) short bf16x8;
typedef __attribute__((ext_vector_type(4))) float f32x4;
typedef unsigned short bf16_t;

#define T_ 32768
#define D_ 2048
#define FF_ 8192
#define MiB (1024l * 1024l)

struct Params { const float* in[19]; float* out; char* ws; };

__device__ __forceinline__ bf16_t f2bf(float f) {
  unsigned u = __float_as_uint(f);
  u += 0x7fffu + ((u >> 16) & 1u);
  return (bf16_t)(u >> 16);
}
__device__ __forceinline__ unsigned pack2(float a, float b) { return (unsigned)f2bf(a) | ((unsigned)f2bf(b) << 16); }
__device__ __forceinline__ float bflo(unsigned u) { return __uint_as_float(u << 16); }
__device__ __forceinline__ float bfhi(unsigned u) { return __uint_as_float(u & 0xffff0000u); }
__device__ __forceinline__ float wave_sum(float v) {
#pragma unroll
  for (int o = 32; o; o >>= 1) v += __shfl_xor(v, o);
  return v;
}
#define WSYNC() do { __builtin_amdgcn_fence(__ATOMIC_SEQ_CST, "workgroup"); __builtin_amdgcn_wave_barrier(); } while (0)

__device__ __forceinline__ void grid_bar(unsigned* cnt, unsigned& epoch) {
  __builtin_amdgcn_fence(__ATOMIC_RELEASE, "agent");
  __syncthreads();
  epoch++;
  if (threadIdx.x == 0) {
    unsigned target = epoch * gridDim.x;
    __hip_atomic_fetch_add(cnt, 1u, __ATOMIC_RELEASE, __HIP_MEMORY_SCOPE_AGENT);
    unsigned sp = 0;
    while (__hip_atomic_load(cnt, __ATOMIC_RELAXED, __HIP_MEMORY_SCOPE_AGENT) < target) {
      __builtin_amdgcn_s_sleep(2);
      if (++sp > (1u << 26)) break;
    }
  }
  __syncthreads();
  __builtin_amdgcn_fence(__ATOMIC_ACQUIRE, "agent");
}

__device__ void transpose_phase(const float* __restrict__ src, bf16_t* __restrict__ dst, int K, int N, int Npad, int batch, char* smem) {
  float* t = (float*)smem;
  const int tid = threadIdx.x;
  const int tk = K / 64, tn = Npad / 64;
  const int total = batch * tk * tn;
  for (int id = blockIdx.x; id < total; id += gridDim.x) {
    int bb = id / (tk * tn); int r = id % (tk * tn); int kt = r / tn, nt = r % tn;
    const float* s = src + (long)bb * K * N; bf16_t* d = dst + (long)bb * Npad * K;
    int k0 = kt * 64, n0 = nt * 64;
    __syncthreads();
#pragma unroll
    for (int i = 0; i < 16; ++i) {
      int kk = i * 4 + (tid >> 6), c = tid & 63, n = n0 + c;
      t[kk * 65 + c] = (n < N) ? s[(long)(k0 + kk) * N + n] : 0.f;
    }
    __syncthreads();
#pragma unroll
    for (int i = 0; i < 16; ++i) {
      int nn = i * 4 + (tid >> 6), kk = tid & 63;
      d[(long)(n0 + nn) * K + k0 + kk] = f2bf(t[kk * 65 + nn]);
    }
  }
}

__device__ __forceinline__ void gemm_phase(const int EPI, const bf16_t* A, int lda, long a_bs, const bf16_t* Bt, int ldb, long b_bs,
                           void* Cv, int ldc, long c_bs, int N, int K, int batch, char* smem) {
  bf16_t* sA = (bf16_t*)smem;
  bf16_t* sB = sA + 128 * 40;
  const int tid = threadIdx.x, lane = tid & 63, wave = tid >> 6;
  const int wm = (wave >> 1) * 64, wn = (wave & 1) * 64;
  const int tn = N / 128;
  const int per = 256 * tn;
  const int total = per * batch;
  const int lr = lane & 15, lg = lane >> 4;
  for (int id = blockIdx.x; id < total; id += gridDim.x) {
    int bb = id / per; int r = id % per;
    int grp = r / (16 * tn); int rem = r % (16 * tn);
    int m0 = (grp * 16 + (rem & 15)) * 128, n0 = (rem >> 4) * 128;
    const bf16_t* Ab = A + bb * a_bs + (long)m0 * lda;
    const bf16_t* Bb = Bt + bb * b_bs + (long)n0 * ldb;
    f32x4 acc[4][4];
#pragma unroll
    for (int i = 0; i < 4; ++i)
#pragma unroll
      for (int j = 0; j < 4; ++j) acc[i][j] = (f32x4){0.f, 0.f, 0.f, 0.f};
    const int r0 = tid >> 2, kc = (tid & 3) * 8;
    const bf16_t* ga0 = Ab + (long)r0 * lda + kc;
    const bf16_t* ga1 = Ab + (long)(r0 + 64) * lda + kc;
    const bf16_t* gb0 = Bb + (long)r0 * ldb + kc;
    const bf16_t* gb1 = Bb + (long)(r0 + 64) * ldb + kc;
    uint4 ra0 = *(const uint4*)ga0, ra1 = *(const uint4*)ga1, rb0 = *(const uint4*)gb0, rb1 = *(const uint4*)gb1;
    for (int k0 = 0; k0 < K; k0 += 32) {
      __syncthreads();
      *(uint4*)(sA + r0 * 40 + kc) = ra0;
      *(uint4*)(sA + (r0 + 64) * 40 + kc) = ra1;
      *(uint4*)(sB + r0 * 40 + kc) = rb0;
      *(uint4*)(sB + (r0 + 64) * 40 + kc) = rb1;
      __syncthreads();
      if (k0 + 32 < K) {
        ra0 = *(const uint4*)(ga0 + k0 + 32); ra1 = *(const uint4*)(ga1 + k0 + 32);
        rb0 = *(const uint4*)(gb0 + k0 + 32); rb1 = *(const uint4*)(gb1 + k0 + 32);
      }
      bf16x8 fa[4], fb[4];
#pragma unroll
      for (int i = 0; i < 4; ++i) fa[i] = *(const bf16x8*)(sA + (wm + i * 16 + lr) * 40 + lg * 8);
#pragma unroll
      for (int j = 0; j < 4; ++j) fb[j] = *(const bf16x8*)(sB + (wn + j * 16 + lr) * 40 + lg * 8);
#pragma unroll
      for (int i = 0; i < 4; ++i)
#pragma unroll
        for (int j = 0; j < 4; ++j) acc[i][j] = __builtin_amdgcn_mfma_f32_16x16x32_bf16(fa[i], fb[j], acc[i][j], 0, 0, 0);
    }
#pragma unroll
    for (int i = 0; i < 4; ++i)
#pragma unroll
      for (int j = 0; j < 4; ++j)
#pragma unroll
        for (int rr = 0; rr < 4; ++rr) {
          long row = m0 + wm + i * 16 + lg * 4 + rr; int col = n0 + wn + j * 16 + lr;
          float v = acc[i][j][rr];
          long off = bb * c_bs + row * ldc + col;
          if (EPI == 0) ((bf16_t*)Cv)[off] = f2bf(v);
          else if (EPI == 1) { float x = fmaxf(v, 0.f); ((bf16_t*)Cv)[off] = f2bf(x * x); }
          else if (EPI == 2) ((float*)Cv)[off] += v;
          else ((float*)Cv)[off] = v;
        }
  }
}

__device__ void rms_phase(const float* src, const float* __restrict__ g, bf16_t* dstb, float* dstf, int mode) {
  const int lane = threadIdx.x & 63;
  const int gw = blockIdx.x * 4 + (threadIdx.x >> 6), nw = gridDim.x * 4;
  for (int row = gw; row < T_; row += nw) {
    const float4* p = (const float4*)(src + (long)row * D_);
    float4 v[8]; float ss = 0.f;
#pragma unroll
    for (int i = 0; i < 8; ++i) { v[i] = p[lane + 64 * i]; ss += v[i].x * v[i].x + v[i].y * v[i].y + v[i].z * v[i].z + v[i].w * v[i].w; }
    ss = wave_sum(ss);
    float rs = rsqrtf(ss * (1.f / D_) + 1e-6f);
#pragma unroll
    for (int i = 0; i < 8; ++i) {
      float4 gg = ((const float4*)g)[lane + 64 * i];
      float4 y; y.x = v[i].x * rs * gg.x; y.y = v[i].y * rs * gg.y; y.z = v[i].z * rs * gg.z; y.w = v[i].w * rs * gg.w;
      if (mode == 2) ((float4*)(dstf + (long)row * D_))[lane + 64 * i] = y;
      else {
        uint2 o; o.x = pack2(y.x, y.y); o.y = pack2(y.z, y.w);
        *(uint2*)(dstb + (long)row * D_ + (lane + 64 * i) * 4) = o;
        if (mode == 1) ((float4*)(dstf + (long)row * D_))[lane + 64 * i] = v[i];
      }
    }
  }
}

__device__ __forceinline__ void mulz(uint4 c, uint4 x, float* z) {
  z[0] = bflo(c.x) * bflo(x.x); z[1] = bfhi(c.x) * bfhi(x.x);
  z[2] = bflo(c.y) * bflo(x.y); z[3] = bfhi(c.y) * bfhi(x.y);
  z[4] = bflo(c.z) * bflo(x.z); z[5] = bfhi(c.z) * bfhi(x.z);
  z[6] = bflo(c.w) * bflo(x.w); z[7] = bfhi(c.w) * bfhi(x.w);
}

__device__ void conv_phase(const bf16_t* proj, const float* __restrict__ cw, bf16_t* u) {
  const long total = (long)T_ * 256;
  for (long id = (long)blockIdx.x * 256 + threadIdx.x; id < total; id += (long)gridDim.x * 256) {
    int tok = (int)(id >> 8); int d0 = (int)(id & 255) * 8; int s = tok & 2047;
    const bf16_t* row = proj + (long)tok * 6144 + d0;
    uint4 bg = *(const uint4*)row;
    float z0[8], z1[8], z2[8];
    mulz(*(const uint4*)(row + 2048), *(const uint4*)(row + 4096), z0);
    if (s >= 1) mulz(*(const uint4*)(row - 6144 + 2048), *(const uint4*)(row - 6144 + 4096), z1);
    else {
#pragma unroll
      for (int i = 0; i < 8; ++i) z1[i] = 0.f;
    }
    if (s >= 2) mulz(*(const uint4*)(row - 12288 + 2048), *(const uint4*)(row - 12288 + 4096), z2);
    else {
#pragma unroll
      for (int i = 0; i < 8; ++i) z2[i] = 0.f;
    }
    float b[8];
    b[0] = bflo(bg.x); b[1] = bfhi(bg.x); b[2] = bflo(bg.y); b[3] = bfhi(bg.y);
    b[4] = bflo(bg.z); b[5] = bfhi(bg.z); b[6] = bflo(bg.w); b[7] = bfhi(bg.w);
    float o[8];
#pragma unroll
    for (int i = 0; i < 8; ++i)
      o[i] = b[i] * (cw[d0 + i] * z2[i] + cw[2048 + d0 + i] * z1[i] + cw[4096 + d0 + i] * z0[i]);
    uint4 ov; ov.x = pack2(o[0], o[1]); ov.y = pack2(o[2], o[3]); ov.z = pack2(o[4], o[5]); ov.w = pack2(o[6], o[7]);
    *(uint4*)(u + (long)tok * D_ + d0) = ov;
  }
}

__device__ void attn_norm_phase(const float* proj, const float* __restrict__ qg, const float* __restrict__ kvg,
                                const float* __restrict__ lng, const float* __restrict__ lnb,
                                bf16_t* cq, bf16_t* ckv, float* kidx, float* widx) {
  const int lane = threadIdx.x & 63;
  const int gw = blockIdx.x * 4 + (threadIdx.x >> 6), nw = gridDim.x * 4;
  for (int tok = gw; tok < T_; tok += nw) {
    const float* r = proj + (long)tok * 896;
    float a[8]; float ss = 0.f;
#pragma unroll
    for (int i = 0; i < 8; ++i) { a[i] = r[lane + 64 * i]; ss += a[i] * a[i]; }
    ss = wave_sum(ss); float rs = rsqrtf(ss * (1.f / 512.f) + 1e-6f);
#pragma unroll
    for (int i = 0; i < 8; ++i) cq[(long)tok * 512 + lane + 64 * i] = f2bf(a[i] * rs * qg[lane + 64 * i]);
    float c[4]; ss = 0.f;
#pragma unroll
    for (int i = 0; i < 4; ++i) { c[i] = r[512 + lane + 64 * i]; ss += c[i] * c[i]; }
    ss = wave_sum(ss); rs = rsqrtf(ss * (1.f / 256.f) + 1e-6f);
#pragma unroll
    for (int i = 0; i < 4; ++i) ckv[(long)tok * 256 + lane + 64 * i] = f2bf(c[i] * rs * kvg[lane + 64 * i]);
    float k = r[768 + lane];
    float mu = wave_sum(k) * (1.f / 64.f); float dk = k - mu;
    float var = wave_sum(dk * dk) * (1.f / 64.f);
    kidx[(long)tok * 64 + lane] = dk * rsqrtf(var + 1e-6f) * lng[lane] + lnb[lane];
    if (lane < 16) widx[(long)tok * 16 + lane] = r[832 + lane] * (1.f / 32.f);
  }
}

__device__ __forceinline__ unsigned okey(float f) {
  unsigned u = __float_as_uint(f);
  return (u & 0x80000000u) ? ~u : (u | 0x80000000u);
}

__device__ void attn_phase(const float* qidx, const float* kidx, const float* widx, const bf16_t* ckv, bf16_t* qlat, char* smem) {
  const int lane = threadIdx.x & 63, w = threadIdx.x >> 6;
  char* base = smem + w * 13312;
  unsigned* keys = (unsigned*)base;
  float* qs = (float*)(base + 8192);
  unsigned short* list = (unsigned short*)(base + 12288);
  bf16_t* P = (bf16_t*)base;
  const int gw = blockIdx.x * 4 + w, nw = gridDim.x * 4;
  const int lr = lane & 15, lg4 = lane >> 4;
  const unsigned long long ltm = (1ull << lane) - 1ull;
  for (int q = gw; q < T_; q += nw) {
    const int b = q >> 11; const int t = ((q & 2047) + b * 131) & 2047;
    const int tok = b * 2048 + t;
    WSYNC();
#pragma unroll
    for (int i = 0; i < 4; ++i) ((float4*)qs)[lane + 64 * i] = ((const float4*)(qidx + (long)tok * 1024))[lane + 64 * i];
    WSYNC();
    const int ntile = (t >> 6) + 1;
    const float* kb = kidx + (long)b * 2048 * 64;
    const float* wrow = widx + (long)tok * 16;
#pragma unroll 1
    for (int tile = 0; tile < ntile; ++tile) {
      int s = tile * 64 + lane;
      const float4* kr = (const float4*)(kb + (long)s * 64);
      float4 k[16];
#pragma unroll
      for (int i = 0; i < 16; ++i) k[i] = kr[i];
      float score = 0.f;
#pragma unroll 1
      for (int h = 0; h < 16; ++h) {
        const float4* qh = (const float4*)(qs + h * 64);
        float d = 0.f;
#pragma unroll
        for (int i = 0; i < 16; ++i) { float4 qq = qh[i]; d += qq.x * k[i].x + qq.y * k[i].y + qq.z * k[i].z + qq.w * k[i].w; }
        score += wrow[h] * fmaxf(d, 0.f);
      }
      keys[s] = (s <= t) ? okey(score) : 0u;
    }
    WSYNC();
    int n;
    if (t < 256) {
      n = t + 1;
      for (int j = lane; j < n; j += 64) list[j] = (unsigned short)j;
    } else {
      n = 256;
      unsigned Tm = 0u;
#pragma unroll 1
      for (int bit = 31; bit >= 0; --bit) {
        unsigned cand = Tm | (1u << bit); int cnt = 0;
        for (int tile = 0; tile < ntile; ++tile) cnt += __popcll(__ballot(keys[tile * 64 + lane] >= cand));
        if (cnt >= 256) Tm = cand;
      }
      int ngt = 0;
      for (int tile = 0; tile < ntile; ++tile) ngt += __popcll(__ballot(keys[tile * 64 + lane] > Tm));
      int eqb = 256 - ngt, eqs = 0, cnt = 0;
      for (int tile = 0; tile < ntile; ++tile) {
        int s = tile * 64 + lane;
        unsigned kx = keys[s]; bool gt = kx > Tm, eq = kx == Tm;
        unsigned long long em = __ballot(eq);
        bool sel = gt || (eq && (eqs + __popcll(em & ltm)) < eqb);
        unsigned long long sm = __ballot(sel);
        if (sel) list[cnt + __popcll(sm & ltm)] = (unsigned short)s;
        cnt += __popcll(sm); eqs += __popcll(em);
      }
    }
    WSYNC();
    bf16_t* qrow = qlat + (long)tok * 4096;
    bf16x8 aq[8];
#pragma unroll
    for (int ks = 0; ks < 8; ++ks) aq[ks] = *(const bf16x8*)(qrow + lr * 256 + ks * 32 + lg4 * 8);
    const bf16_t* cb = ckv + (long)b * 2048 * 256;
    f32x4 lgt[16];
    const float scale = 0.08838834764831845f;
#pragma unroll
    for (int jt = 0; jt < 16; ++jt) {
      if (jt * 16 < n) {
        int j = jt * 16 + lr; int idx = list[j < n ? j : 0];
        const bf16_t* kr = cb + (long)idx * 256 + lg4 * 8;
        f32x4 acc = (f32x4){0.f, 0.f, 0.f, 0.f};
#pragma unroll
        for (int ks = 0; ks < 8; ++ks) acc = __builtin_amdgcn_mfma_f32_16x16x32_bf16(aq[ks], *(const bf16x8*)(kr + ks * 32), acc, 0, 0, 0);
#pragma unroll
        for (int r = 0; r < 4; ++r) lgt[jt][r] = (j < n) ? acc[r] * scale : -INFINITY;
      } else {
        lgt[jt] = (f32x4){-INFINITY, -INFINITY, -INFINITY, -INFINITY};
      }
    }
    float mx[4], sm4[4];
#pragma unroll
    for (int r = 0; r < 4; ++r) {
      float m = lgt[0][r];
#pragma unroll
      for (int jt = 1; jt < 16; ++jt) m = fmaxf(m, lgt[jt][r]);
      m = fmaxf(m, __shfl_xor(m, 1)); m = fmaxf(m, __shfl_xor(m, 2)); m = fmaxf(m, __shfl_xor(m, 4)); m = fmaxf(m, __shfl_xor(m, 8));
      mx[r] = m;
      float s = 0.f;
#pragma unroll
      for (int jt = 0; jt < 16; ++jt) { float e = __expf(lgt[jt][r] - m); lgt[jt][r] = e; s += e; }
      s += __shfl_xor(s, 1); s += __shfl_xor(s, 2); s += __shfl_xor(s, 4); s += __shfl_xor(s, 8);
      sm4[r] = 1.f / s;
    }
    WSYNC();
#pragma unroll
    for (int jt = 0; jt < 16; ++jt) {
      if (jt * 16 < n) {
        int j = jt * 16 + lr;
        uint2 pv; pv.x = pack2(lgt[jt][0] * sm4[0], lgt[jt][1] * sm4[1]); pv.y = pack2(lgt[jt][2] * sm4[2], lgt[jt][3] * sm4[3]);
        *(uint2*)(P + j * 16 + lg4 * 4) = pv;
      }
    }
    WSYNC();
    float o[16][4];
#pragma unroll
    for (int h = 0; h < 16; ++h) { o[h][0] = 0.f; o[h][1] = 0.f; o[h][2] = 0.f; o[h][3] = 0.f; }
#pragma unroll 1
    for (int j = 0; j < n; ++j) {
      int idx = list[j];
      uint2 vv = *(const uint2*)(cb + (long)idx * 256 + lane * 4);
      float v0 = bflo(vv.x), v1 = bfhi(vv.x), v2 = bflo(vv.y), v3 = bfhi(vv.y);
      uint4 p0 = *(const uint4*)(P + j * 16), p1 = *(const uint4*)(P + j * 16 + 8);
      unsigned pw[8] = {p0.x, p0.y, p0.z, p0.w, p1.x, p1.y, p1.z, p1.w};
#pragma unroll
      for (int hh = 0; hh < 8; ++hh) {
        float pa = bflo(pw[hh]), pb = bfhi(pw[hh]);
        o[2 * hh][0] += pa * v0; o[2 * hh][1] += pa * v1; o[2 * hh][2] += pa * v2; o[2 * hh][3] += pa * v3;
        o[2 * hh + 1][0] += pb * v0; o[2 * hh + 1][1] += pb * v1; o[2 * hh + 1][2] += pb * v2; o[2 * hh + 1][3] += pb * v3;
      }
    }
#pragma unroll
    for (int h = 0; h < 16; ++h) {
      uint2 ov; ov.x = pack2(o[h][0], o[h][1]); ov.y = pack2(o[h][2], o[h][3]);
      *(uint2*)(qrow + h * 256 + lane * 4) = ov;
    }
  }
}

__global__ __launch_bounds__(256, 2) void mega_kernel(Params p) {
  __shared__ __attribute__((aligned(16))) char smem[53248];
  unsigned epoch = 0; unsigned* bar = (unsigned*)p.ws;
  float* h = p.out;
  bf16_t* HN = (bf16_t*)(p.ws + 4096);
  char* BIGc = p.ws + 4096 + 128 * MiB;
  bf16_t* BIG = (bf16_t*)BIGc;
  bf16_t* W1T = (bf16_t*)(BIGc + 512 * MiB);
  bf16_t* W2T = W1T + 16 * MiB;
  bf16_t* WM = W2T + 16 * MiB;
  char* SM = (char*)(WM + 16 * MiB);
  bf16_t* CQ = (bf16_t*)SM;
  bf16_t* CKV = (bf16_t*)(SM + 32 * MiB);
  float* KIDX = (float*)(SM + 48 * MiB);
  float* WIDX = (float*)(SM + 56 * MiB);
  bf16_t* inT = WM; bf16_t* uqT = WM + 1835008; bf16_t* qiT = WM + 2883584; bf16_t* ukT = WM + 3407872;
  bf16_t* uvT = WM + 3932160; bf16_t* aoT = WM + 4456448; bf16_t* coT = WM + 12582912;
  float* PROJ = (float*)BIGc;
  float* QIDX = (float*)(BIGc + 256 * MiB);

#pragma unroll 1
  for (int L = 0; L <= 4; ++L) {
    const int j = L >> 1;
    const bool at = (L & 1) != 0;
#pragma unroll 1
    for (int step = 0; step < 12; ++step) {
      int type = 5;
      int epi = 0; const bf16_t* gA = HN; int lda = D_; long abs_ = 0; const bf16_t* gB = inT; int ldb = D_; long bbs = 0;
      void* gC = BIG; int ldc = D_; long cbs = 0; int gN = D_, gK = D_, gbatch = 1;
      const float* rsrc = h; const float* rg = p.in[18]; int rmode = 2;
      if (L == 4) { if (step == 0) type = 0; }
      else if (step == 0) { type = 0; rsrc = (L == 0) ? p.in[0] : h; rg = p.in[1] + L * D_; rmode = (L == 0) ? 1 : 0; }
      else if (step == 1) { type = 1; if (!at) { epi = 0; gC = BIG; ldc = 6144; gN = 6144; } else { epi = 3; gC = PROJ; ldc = 896; gN = 896; } }
      else if (step == 2) { type = at ? 3 : 2; }
      else if (step == 3) { if (at) { type = 1; epi = 0; gA = CQ; lda = 512; gB = uqT; ldb = 512; gC = HN; ldc = D_; gN = 2048; gK = 512; } }
      else if (step == 4) { if (at) { type = 1; epi = 3; gA = CQ; lda = 512; gB = qiT; ldb = 512; gC = QIDX; ldc = 1024; gN = 1024; gK = 512; } }
      else if (step == 5) { if (at) { type = 1; epi = 0; gA = HN; lda = D_; abs_ = 128; gB = ukT; ldb = 128; bbs = 256 * 128; gC = BIG; ldc = 4096; cbs = 256; gN = 256; gK = 128; gbatch = 16; } }
      else if (step == 6) { if (at) type = 4; }
      else if (step == 7) { if (at) { type = 1; epi = 0; gA = BIG; lda = 4096; abs_ = 256; gB = uvT; ldb = 256; bbs = 128 * 256; gC = HN; ldc = D_; cbs = 128; gN = 128; gK = 256; gbatch = 16; } }
      else if (step == 8) { type = 1; epi = 2; gB = at ? aoT : coT; gC = h; }
      else if (step == 9) { type = 0; rsrc = h; rg = p.in[2] + L * D_; rmode = 0; }
      else if (step == 10) { type = 1; epi = 1; gB = W1T; gC = BIG; ldc = FF_; gN = FF_; }
      else { type = 1; epi = 2; gA = BIG; lda = FF_; gB = W2T; ldb = FF_; gC = h; gK = FF_; }
      if (type == 5) continue;
      if (type == 0) {
        rms_phase(rsrc, rg, HN, h, rmode);
        if (step == 0 && L < 4) {
#pragma unroll 1
          for (int ti = 0; ti < 8; ++ti) {
            const float* ts = nullptr; bf16_t* td = nullptr; int tK = 0, tN = 0, tNp = 0, tb = 1;
            if (ti == 0) { ts = p.in[3] + (long)L * D_ * FF_; td = W1T; tK = D_; tN = FF_; tNp = FF_; }
            else if (ti == 1) { ts = p.in[4] + (long)L * D_ * FF_; td = W2T; tK = FF_; tN = D_; tNp = D_; }
            else if (!at) {
              if (ti == 2) { ts = p.in[5] + (long)j * D_ * 6144; td = inT; tK = D_; tN = 6144; tNp = 6144; }
              else if (ti == 3) { ts = p.in[7] + (long)j * D_ * D_; td = coT; tK = D_; tN = D_; tNp = D_; }
            } else {
              if (ti == 2) { ts = p.in[8] + (long)j * D_ * 848; td = inT; tK = D_; tN = 848; tNp = 896; }
              else if (ti == 3) { ts = p.in[11] + (long)j * 512 * 2048; td = uqT; tK = 512; tN = 2048; tNp = 2048; }
              else if (ti == 4) { ts = p.in[14] + (long)j * 512 * 1024; td = qiT; tK = 512; tN = 1024; tNp = 1024; }
              else if (ti == 5) { ts = p.in[12] + (long)j * 16 * 128 * 256; td = ukT; tK = 128; tN = 256; tNp = 256; tb = 16; }
              else if (ti == 6) { ts = p.in[13] + (long)j * 16 * 256 * 128; td = uvT; tK = 256; tN = 128; tNp = 128; tb = 16; }
              else { ts = p.in[17] + (long)j * D_ * D_; td = aoT; tK = D_; tN = D_; tNp = D_; }
            }
            if (ts != nullptr) transpose_phase(ts, td, tK, tN, tNp, tb, smem);
          }
        }
      } else if (type == 1) {
        gemm_phase(epi, gA, lda, abs_, gB, ldb, bbs, gC, ldc, cbs, gN, gK, gbatch, smem);
      } else if (type == 2) {
        conv_phase(BIG, p.in[6] + (long)j * 3 * D_, HN);
      } else if (type == 3) {
        attn_norm_phase(PROJ, p.in[9] + j * 512, p.in[10] + j * 256, p.in[15] + j * 64, p.in[16] + j * 64, CQ, CKV, KIDX, WIDX);
      } else {
        attn_phase(QIDX, KIDX, WIDX, CKV, BIG, smem);
      }
      if (L < 4) grid_bar(bar, epoch);
    }
  }
}

extern "C" void kernel_launch(void* const* d_in, const int* in_sizes, int n_in,
                              void* d_out, int out_size, void* d_ws, size_t ws_size,
                              hipStream_t stream) {
  Params p{};
  for (int i = 0; i < 19; ++i) p.in[i] = (const float*)d_in[i];
  p.out = (float*)d_out; p.ws = (char*)d_ws;
  hipMemsetAsync(d_ws, 0, 4096, stream);
  int occ = 0;
  hipOccupancyMaxActiveBlocksPerMultiprocessor(&occ, mega_kernel, 256, 0);
  int dev = 0; hipGetDevice(&dev);
  int ncu = 256; hipDeviceGetAttribute(&ncu, hipDeviceAttributeMultiprocessorCount, dev);
  int per = occ < 1 ? 1 : (occ > 2 ? 2 : occ);
  mega_kernel<<<dim3(ncu * per), dim3(256), 0, stream>>>(p);
}
```

```cpp
#include <hip/hip_runtime.h>
#include <hip/hip_bf16.h>
#include <stdint.h>

typedef __attribute__((ext_vector_type(8))) short bf16x8;
typedef __attribute__((ext_vector_type(4))) float f32x4;
typedef unsigned short bf16_t;

#define T_ 32768
#define D_ 2048
#define FF_ 8192
#define MiB (1024l * 1024l)

struct Params { const float* in[19]; float* out; char* ws; };

__device__ __forceinline__ bf16_t f2bf(float f) {
  unsigned u = __float_as_uint(f);
  u += 0x7fffu + ((u >> 16) & 1u);
  return (bf16_t)(u >> 16);
}
__device__ __forceinline__ unsigned pack2(float a, float b) { return (unsigned)f2bf(a) | ((unsigned)f2bf(b) << 16); }
__device__ __forceinline__ float bflo(unsigned u) { return __uint_as_float(u << 16); }
__device__ __forceinline__ float bfhi(unsigned u) { return __uint_as_float(u & 0xffff0000u); }
__device__ __forceinline__ float wave_sum(float v) {
#pragma unroll
  for (int o = 32; o; o >>= 1) v += __shfl_xor(v, o);
  return v;
}
#define WSYNC() do { __builtin_amdgcn_fence(__ATOMIC_SEQ_CST, "workgroup"); __builtin_amdgcn_wave_barrier(); } while (0)

__device__ __forceinline__ void grid_bar(unsigned* cnt, unsigned& epoch) {
  __builtin_amdgcn_fence(__ATOMIC_RELEASE, "agent");
  __syncthreads();
  epoch++;
  if (threadIdx.x == 0) {
    unsigned target = epoch * gridDim.x;
    __hip_atomic_fetch_add(cnt, 1u, __ATOMIC_RELEASE, __HIP_MEMORY_SCOPE_AGENT);
    unsigned sp = 0;
    while (__hip_atomic_load(cnt, __ATOMIC_RELAXED, __HIP_MEMORY_SCOPE_AGENT) < target) {
      __builtin_amdgcn_s_sleep(2);
      if (++sp > (1u << 26)) break;
    }
  }
  __syncthreads();
  __builtin_amdgcn_fence(__ATOMIC_ACQUIRE, "agent");
}

__device__ void transpose_phase(const float* __restrict__ src, bf16_t* __restrict__ dst, int K, int N, int Npad, int batch, char* smem) {
  float* t = (float*)smem;
  const int tid = threadIdx.x;
  const int tk = K / 64, tn = Npad / 64;
  const int total = batch * tk * tn;
  for (int id = blockIdx.x; id < total; id += gridDim.x) {
    int bb = id / (tk * tn); int r = id % (tk * tn); int kt = r / tn, nt = r % tn;
    const float* s = src + (long)bb * K * N; bf16_t* d = dst + (long)bb * Npad * K;
    int k0 = kt * 64, n0 = nt * 64;
    __syncthreads();
#pragma unroll
    for (int i = 0; i < 16; ++i) {
      int kk = i * 4 + (tid >> 6), c = tid & 63, n = n0 + c;
      t[kk * 65 + c] = (n < N) ? s[(long)(k0 + kk) * N + n] : 0.f;
    }
    __syncthreads();
#pragma unroll
    for (int i = 0; i < 16; ++i) {
      int nn = i * 4 + (tid >> 6), kk = tid & 63;
      d[(long)(n0 + nn) * K + k0 + kk] = f2bf(t[kk * 65 + nn]);
    }
  }
}

__device__ __forceinline__ void gemm_phase(const int EPI, const bf16_t* A, int lda, long a_bs, const bf16_t* Bt, int ldb, long b_bs,
                           void* Cv, int ldc, long c_bs, int N, int K, int batch, char* smem) {
  bf16_t* sA = (bf16_t*)smem;
  bf16_t* sB = sA + 128 * 40;
  const int tid = threadIdx.x, lane = tid & 63, wave = tid >> 6;
  const int wm = (wave >> 1) * 64, wn = (wave & 1) * 64;
  const int tn = N / 128;
  const int per = 256 * tn;
  const int total = per * batch;
  const int lr = lane & 15, lg = lane >> 4;
  for (int id = blockIdx.x; id < total; id += gridDim.x) {
    int bb = id / per; int r = id % per;
    int grp = r / (16 * tn); int rem = r % (16 * tn);
    int m0 = (grp * 16 + (rem & 15)) * 128, n0 = (rem >> 4) * 128;
    const bf16_t* Ab = A + bb * a_bs + (long)m0 * lda;
    const bf16_t* Bb = Bt + bb * b_bs + (long)n0 * ldb;
    f32x4 acc[4][4];
#pragma unroll
    for (int i = 0; i < 4; ++i)
#pragma unroll
      for (int j = 0; j < 4; ++j) acc[i][j] = (f32x4){0.f, 0.f, 0.f, 0.f};
    const int r0 = tid >> 2, kc = (tid & 3) * 8;
    const bf16_t* ga0 = Ab + (long)r0 * lda + kc;
    const bf16_t* ga1 = Ab + (long)(r0 + 64) * lda + kc;
    const bf16_t* gb0 = Bb + (long)r0 * ldb + kc;
    const bf16_t* gb1 = Bb + (long)(r0 + 64) * ldb + kc;
    uint4 ra0 = *(const uint4*)ga0, ra1 = *(const uint4*)ga1, rb0 = *(const uint4*)gb0, rb1 = *(const uint4*)gb1;
    __syncthreads();
    *(uint4*)(sA + r0 * 40 + kc) = ra0;
    *(uint4*)(sA + (r0 + 64) * 40 + kc) = ra1;
    *(uint4*)(sB + r0 * 40 + kc) = rb0;
    *(uint4*)(sB + (r0 + 64) * 40 + kc) = rb1;
    __syncthreads();
    int cur = 0;
    for (int k0 = 0; k0 < K; k0 += 32) {
      const bool more = (k0 + 32 < K);
      if (more) {
        ra0 = *(const uint4*)(ga0 + k0 + 32); ra1 = *(const uint4*)(ga1 + k0 + 32);
        rb0 = *(const uint4*)(gb0 + k0 + 32); rb1 = *(const uint4*)(gb1 + k0 + 32);
      }
      const bf16_t* cA = sA + cur * 10240;
      const bf16_t* cB = sB + cur * 10240;
      bf16x8 fa[4], fb[4];
#pragma unroll
      for (int i = 0; i < 4; ++i) fa[i] = *(const bf16x8*)(cA + (wm + i * 16 + lr) * 40 + lg * 8);
#pragma unroll
      for (int j = 0; j < 4; ++j) fb[j] = *(const bf16x8*)(cB + (wn + j * 16 + lr) * 40 + lg * 8);
#pragma unroll
      for (int i = 0; i < 4; ++i)
#pragma unroll
        for (int j = 0; j < 4; ++j) acc[i][j] = __builtin_amdgcn_mfma_f32_16x16x32_bf16(fa[i], fb[j], acc[i][j], 0, 0, 0);
      if (more) {
        bf16_t* nA = sA + (cur ^ 1) * 10240;
        bf16_t* nB = sB + (cur ^ 1) * 10240;
        *(uint4*)(nA + r0 * 40 + kc) = ra0;
        *(uint4*)(nA + (r0 + 64) * 40 + kc) = ra1;
        *(uint4*)(nB + r0 * 40 + kc) = rb0;
        *(uint4*)(nB + (r0 + 64) * 40 + kc) = rb1;
      }
      __syncthreads();
      cur ^= 1;
    }
#pragma unroll
    for (int i = 0; i < 4; ++i)
#pragma unroll
      for (int j = 0; j < 4; ++j)
#pragma unroll
        for (int rr = 0; rr < 4; ++rr) {
          long row = m0 + wm + i * 16 + lg * 4 + rr; int col = n0 + wn + j * 16 + lr;
          float v = acc[i][j][rr];
          long off = bb * c_bs + row * ldc + col;
          if (EPI == 0) ((bf16_t*)Cv)[off] = f2bf(v);
          else if (EPI == 1) { float x = fmaxf(v, 0.f); ((bf16_t*)Cv)[off] = f2bf(x * x); }
          else if (EPI == 2) ((float*)Cv)[off] += v;
          else ((float*)Cv)[off] = v;
        }
  }
}

__device__ void rms_phase(const float* src, const float* __restrict__ g, bf16_t* dstb, float* dstf, int mode) {
  const int lane = threadIdx.x & 63;
  const int gw = blockIdx.x * 4 + (threadIdx.x >> 6), nw = gridDim.x * 4;
  for (int row = gw; row < T_; row += nw) {
    const float4* p = (const float4*)(src + (long)row * D_);
    float4 v[8]; float ss = 0.f;
#pragma unroll
    for (int i = 0; i < 8; ++i) { v[i] = p[lane + 64 * i]; ss += v[i].x * v[i].x + v[i].y * v[i].y + v[i].z * v[i].z + v[i].w * v[i].w; }
    ss = wave_sum(ss);
    float rs = rsqrtf(ss * (1.f / D_) + 1e-6f);
#pragma unroll
    for (int i = 0; i < 8; ++i) {
      float4 gg = ((const float4*)g)[lane + 64 * i];
      float4 y; y.x = v[i].x * rs * gg.x; y.y = v[i].y * rs * gg.y; y.z = v[i].z * rs * gg.z; y.w = v[i].w * rs * gg.w;
      if (mode == 2) ((float4*)(dstf + (long)row * D_))[lane + 64 * i] = y;
      else {
        uint2 o; o.x = pack2(y.x, y.y); o.y = pack2(y.z, y.w);
        *(uint2*)(dstb + (long)row * D_ + (lane + 64 * i) * 4) = o;
        if (mode == 1) ((float4*)(dstf + (long)row * D_))[lane + 64 * i] = v[i];
      }
    }
  }
}

__device__ __forceinline__ void mulz(uint4 c, uint4 x, float* z) {
  z[0] = bflo(c.x) * bflo(x.x); z[1] = bfhi(c.x) * bfhi(x.x);
  z[2] = bflo(c.y) * bflo(x.y); z[3] = bfhi(c.y) * bfhi(x.y);
  z[4] = bflo(c.z) * bflo(x.z); z[5] = bfhi(c.z) * bfhi(x.z);
  z[6] = bflo(c.w) * bflo(x.w); z[7] = bfhi(c.w) * bfhi(x.w);
}

__device__ void conv_phase(const bf16_t* proj, const float* __restrict__ cw, bf16_t* u) {
  const long total = (long)T_ * 256;
  for (long id = (long)blockIdx.x * 256 + threadIdx.x; id < total; id += (long)gridDim.x * 256) {
    int tok = (int)(id >> 8); int d0 = (int)(id & 255) * 8; int s = tok & 2047;
    const bf16_t* row = proj + (long)tok * 6144 + d0;
    uint4 bg = *(const uint4*)row;
    float z0[8], z1[8], z2[8];
    mulz(*(const uint4*)(row + 2048), *(const uint4*)(row + 4096), z0);
    if (s >= 1) mulz(*(const uint4*)(row - 6144 + 2048), *(const uint4*)(row - 6144 + 4096), z1);
    else {
#pragma unroll
      for (int i = 0; i < 8; ++i) z1[i] = 0.f;
    }
    if (s >= 2) mulz(*(const uint4*)(row - 12288 + 2048), *(const uint4*)(row - 12288 + 4096), z2);
    else {
#pragma unroll
      for (int i = 0; i < 8; ++i) z2[i] = 0.f;
    }
    float b[8];
    b[0] = bflo(bg.x); b[1] = bfhi(bg.x); b[2] = bflo(bg.y); b[3] = bfhi(bg.y);
    b[4] = bflo(bg.z); b[5] = bfhi(bg.z); b[6] = bflo(bg.w); b[7] = bfhi(bg.w);
    float o[8];
#pragma unroll
    for (int i = 0; i < 8; ++i)
      o[i] = b[i] * (cw[d0 + i] * z2[i] + cw[2048 + d0 + i] * z1[i] + cw[4096 + d0 + i] * z0[i]);
    uint4 ov; ov.x = pack2(o[0], o[1]); ov.y = pack2(o[2], o[3]); ov.z = pack2(o[4], o[5]); ov.w = pack2(o[6], o[7]);
    *(uint4*)(u + (long)tok * D_ + d0) = ov;
  }
}

__device__ void attn_norm_phase(const float* proj, const float* __restrict__ qg, const float* __restrict__ kvg,
                                const float* __restrict__ lng, const float* __restrict__ lnb,
                                bf16_t* cq, bf16_t* ckv, float* kidx, float* widx) {
  const int lane = threadIdx.x & 63;
  const int gw = blockIdx.x * 4 + (threadIdx.x >> 6), nw = gridDim.x * 4;
  for (int tok = gw; tok < T_; tok += nw) {
    const float* r = proj + (long)tok * 896;
    float a[8]; float ss = 0.f;
#pragma unroll
    for (int i = 0; i < 8; ++i) { a[i] = r[lane + 64 * i]; ss += a[i] * a[i]; }
    ss = wave_sum(ss); float rs = rsqrtf(ss * (1.f / 512.f) + 1e-6f);
#pragma unroll
    for (int i = 0; i < 8; ++i) cq[(long)tok * 512 + lane + 64 * i] = f2bf(a[i] * rs * qg[lane + 64 * i]);
    float c[4]; ss = 0.f;
#pragma unroll
    for (int i = 0; i < 4; ++i) { c[i] = r[512 + lane + 64 * i]; ss += c[i] * c[i]; }
    ss = wave_sum(ss); rs = rsqrtf(ss * (1.f / 256.f) + 1e-6f);
#pragma unroll
    for (int i = 0; i < 4; ++i) ckv[(long)tok * 256 + lane + 64 * i] = f2bf(c[i] * rs * kvg[lane + 64 * i]);
    float k = r[768 + lane];
    float mu = wave_sum(k) * (1.f / 64.f); float dk = k - mu;
    float var = wave_sum(dk * dk) * (1.f / 64.f);
    kidx[(long)tok * 64 + lane] = dk * rsqrtf(var + 1e-6f) * lng[lane] + lnb[lane];
    if (lane < 16) widx[(long)tok * 16 + lane] = r[832 + lane] * (1.f / 32.f);
  }
}

__device__ __forceinline__ unsigned okey(float f) {
  unsigned u = __float_as_uint(f);
  return (u & 0x80000000u) ? ~u : (u | 0x80000000u);
}

__device__ void attn_phase(const float* qidx, const float* kidx, const float* widx, const bf16_t* ckv, bf16_t* qlat, char* smem) {
  const int lane = threadIdx.x & 63, w = threadIdx.x >> 6;
  char* base = smem + w * 13312;
  unsigned* keys = (unsigned*)base;
  float* qs = (float*)(base + 8192);
  unsigned short* list = (unsigned short*)(base + 12288);
  bf16_t* P = (bf16_t*)base;
  const int gw = blockIdx.x * 4 + w, nw = gridDim.x * 4;
  const int lr = lane & 15, lg4 = lane >> 4;
  const unsigned long long ltm = (1ull << lane) - 1ull;
  for (int q = gw; q < T_; q += nw) {
    const int b = q >> 11; const int t = ((q & 2047) + b * 131) & 2047;
    const int tok = b * 2048 + t;
    WSYNC();
#pragma unroll
    for (int i = 0; i < 4; ++i) ((float4*)qs)[lane + 64 * i] = ((const float4*)(qidx + (long)tok * 1024))[lane + 64 * i];
    WSYNC();
    const int ntile = (t >> 6) + 1;
    const float* kb = kidx + (long)b * 2048 * 64;
    const float* wrow = widx + (long)tok * 16;
#pragma unroll 1
    for (int tile = 0; tile < ntile; ++tile) {
      int s = tile * 64 + lane;
      const float4* kr = (const float4*)(kb + (long)s * 64);
      float4 k[16];
#pragma unroll
      for (int i = 0; i < 16; ++i) k[i] = kr[i];
      float score = 0.f;
#pragma unroll 1
      for (int h = 0; h < 16; ++h) {
        const float4* qh = (const float4*)(qs + h * 64);
        float d = 0.f;
#pragma unroll
        for (int i = 0; i < 16; ++i) { float4 qq = qh[i]; d += qq.x * k[i].x + qq.y * k[i].y + qq.z * k[i].z + qq.w * k[i].w; }
        score += wrow[h] * fmaxf(d, 0.f);
      }
      keys[s] = (s <= t) ? okey(score) : 0u;
    }
    WSYNC();
    int n;
    if (t < 256) {
      n = t + 1;
      for (int j = lane; j < n; j += 64) list[j] = (unsigned short)j;
    } else {
      n = 256;
      unsigned Tm = 0u;
#pragma unroll 1
      for (int bit = 31; bit >= 0; --bit) {
        unsigned cand = Tm | (1u << bit); int cnt = 0;
        for (int tile = 0; tile < ntile; ++tile) cnt += __popcll(__ballot(keys[tile * 64 + lane] >= cand));
        if (cnt >= 256) Tm = cand;
      }
      int ngt = 0;
      for (int tile = 0; tile < ntile; ++tile) ngt += __popcll(__ballot(keys[tile * 64 + lane] > Tm));
      int eqb = 256 - ngt, eqs = 0, cnt = 0;
      for (int tile = 0; tile < ntile; ++tile) {
        int s = tile * 64 + lane;
        unsigned kx = keys[s]; bool gt = kx > Tm, eq = kx == Tm;
        unsigned long long em = __ballot(eq);
        bool sel = gt || (eq && (eqs + __popcll(em & ltm)) < eqb);
        unsigned long long sm = __ballot(sel);
        if (sel) list[cnt + __popcll(sm & ltm)] = (unsigned short)s;
        cnt += __popcll(sm); eqs += __popcll(em);
      }
    }
    WSYNC();
    bf16_t* qrow = qlat + (long)tok * 4096;
    bf16x8 aq[8];
#pragma unroll
    for (int ks = 0; ks < 8; ++ks) aq[ks] = *(const bf16x8*)(qrow + lr * 256 + ks * 32 + lg4 * 8);
    const bf16_t* cb = ckv + (long)b * 2048 * 256;
    f32x4 lgt[16];
    const float scale = 0.08838834764831845f;
#pragma unroll
    for (int jt = 0; jt < 16; ++jt) {
      if (jt * 16 < n) {
        int j = jt * 16 + lr; int idx = list[j < n ? j : 0];
        const bf16_t* kr = cb + (long)idx * 256 + lg4 * 8;
        f32x4 acc = (f32x4){0.f, 0.f, 0.f, 0.f};
#pragma unroll
        for (int ks = 0; ks < 8; ++ks) acc = __builtin_amdgcn_mfma_f32_16x16x32_bf16(aq[ks], *(const bf16x8*)(kr + ks * 32), acc, 0, 0, 0);
#pragma unroll
        for (int r = 0; r < 4; ++r) lgt[jt][r] = (j < n) ? acc[r] * scale : -INFINITY;
      } else {
        lgt[jt] = (f32x4){-INFINITY, -INFINITY, -INFINITY, -INFINITY};
      }
    }
    float mx[4], sm4[4];
#pragma unroll
    for (int r = 0; r < 4; ++r) {
      float m = lgt[0][r];
#pragma unroll
      for (int jt = 1; jt < 16; ++jt) m = fmaxf(m, lgt[jt][r]);
      m = fmaxf(m, __shfl_xor(m, 1)); m = fmaxf(m, __shfl_xor(m, 2)); m = fmaxf(m, __shfl_xor(m, 4)); m = fmaxf(m, __shfl_xor(m, 8));
      mx[r] = m;
      float s = 0.f;
#pragma unroll
      for (int jt = 0; jt < 16; ++jt) { float e = __expf(lgt[jt][r] - m); lgt[jt][r] = e; s += e; }
      s += __shfl_xor(s, 1); s += __shfl_xor(s, 2); s += __shfl_xor(s, 4); s += __shfl_xor(s, 8);
      sm4[r] = 1.f / s;
    }
    WSYNC();
#pragma unroll
    for (int jt = 0; jt < 16; ++jt) {
      if (jt * 16 < n) {
        int j = jt * 16 + lr;
        uint2 pv; pv.x = pack2(lgt[jt][0] * sm4[0], lgt[jt][1] * sm4[1]); pv.y = pack2(lgt[jt][2] * sm4[2], lgt[jt][3] * sm4[3]);
        *(uint2*)(P + j * 16 + lg4 * 4) = pv;
      }
    }
    WSYNC();
    float o[16][4];
#pragma unroll
    for (int h = 0; h < 16; ++h) { o[h][0] = 0.f; o[h][1] = 0.f; o[h][2] = 0.f; o[h][3] = 0.f; }
#pragma unroll 1
    for (int j = 0; j < n; ++j) {
      int idx = list[j];
      uint2 vv = *(const uint2*)(cb + (long)idx * 256 + lane * 4);
      float v0 = bflo(vv.x), v1 = bfhi(vv.x), v2 = bflo(vv.y), v3 = bfhi(vv.y);
      uint4 p0 = *(const uint4*)(P + j * 16), p1 = *(const uint4*)(P + j * 16 + 8);
      unsigned pw[8] = {p0.x, p0.y, p0.z, p0.w, p1.x, p1.y, p1.z, p1.w};
#pragma unroll
      for (int hh = 0; hh < 8; ++hh) {
        float pa = bflo(pw[hh]), pb = bfhi(pw[hh]);
        o[2 * hh][0] += pa * v0; o[2 * hh][1] += pa * v1; o[2 * hh][2] += pa * v2; o[2 * hh][3] += pa * v3;
        o[2 * hh + 1][0] += pb * v0; o[2 * hh + 1][1] += pb * v1; o[2 * hh + 1][2] += pb * v2; o[2 * hh + 1][3] += pb * v3;
      }
    }
#pragma unroll
    for (int h = 0; h < 16; ++h) {
      uint2 ov; ov.x = pack2(o[h][0], o[h][1]); ov.y = pack2(o[h][2], o[h][3]);
      *(uint2*)(qrow + h * 256 + lane * 4) = ov;
    }
  }
}

__global__ __launch_bounds__(256, 2) void mega_kernel(Params p) {
  __shared__ __attribute__((aligned(16))) char smem[53248];
  unsigned epoch = 0; unsigned* bar = (unsigned*)p.ws;
  float* h = p.out;
  bf16_t* HN = (bf16_t*)(p.ws + 4096);
  char* BIGc = p.ws + 4096 + 128 * MiB;
  bf16_t* BIG = (bf16_t*)BIGc;
  bf16_t* W1T = (bf16_t*)(BIGc + 512 * MiB);
  bf16_t* W2T = W1T + 16 * MiB;
  bf16_t* WM = W2T + 16 * MiB;
  char* SM = (char*)(WM + 16 * MiB);
  bf16_t* CQ = (bf16_t*)SM;
  bf16_t* CKV = (bf16_t*)(SM + 32 * MiB);
  float* KIDX = (float*)(SM + 48 * MiB);
  float* WIDX = (float*)(SM + 56 * MiB);
  bf16_t* inT = WM; bf16_t* uqT = WM + 1835008; bf16_t* qiT = WM + 2883584; bf16_t* ukT = WM + 3407872;
  bf16_t* uvT = WM + 3932160; bf16_t* aoT = WM + 4456448; bf16_t* coT = WM + 12582912;
  float* PROJ = (float*)BIGc;
  float* QIDX = (float*)(BIGc + 256 * MiB);

#pragma unroll 1
  for (int L = 0; L <= 4; ++L) {
    const int j = L >> 1;
    const bool at = (L & 1) != 0;
#pragma unroll 1
    for (int step = 0; step < 12; ++step) {
      int type = 5;
      int epi = 0; const bf16_t* gA = HN; int lda = D_; long abs_ = 0; const bf16_t* gB = inT; int ldb = D_; long bbs = 0;
      void* gC = BIG; int ldc = D_; long cbs = 0; int gN = D_, gK = D_, gbatch = 1;
      const float* rsrc = h; const float* rg = p.in[18]; int rmode = 2;
      if (L == 4) { if (step == 0) type = 0; }
      else if (step == 0) { type = 0; rsrc = (L == 0) ? p.in[0] : h; rg = p.in[1] + L * D_; rmode = (L == 0) ? 1 : 0; }
      else if (step == 1) { type = 1; if (!at) { epi = 0; gC = BIG; ldc = 6144; gN = 6144; } else { epi = 3; gC = PROJ; ldc = 896; gN = 896; } }
      else if (step == 2) { type = at ? 3 : 2; }
      else if (step == 3) { if (at) { type = 1; epi = 0; gA = CQ; lda = 512; gB = uqT; ldb = 512; gC = HN; ldc = D_; gN = 2048; gK = 512; } }
      else if (step == 4) { if (at) { type = 1; epi = 3; gA = CQ; lda = 512; gB = qiT; ldb = 512; gC = QIDX; ldc = 1024; gN = 1024; gK = 512; } }
      else if (step == 5) { if (at) { type = 1; epi = 0; gA = HN; lda = D_; abs_ = 128; gB = ukT; ldb = 128; bbs = 256 * 128; gC = BIG; ldc = 4096; cbs = 256; gN = 256; gK = 128; gbatch = 16; } }
      else if (step == 6) { if (at) type = 4; }
      else if (step == 7) { if (at) { type = 1; epi = 0; gA = BIG; lda = 4096; abs_ = 256; gB = uvT; ldb = 256; bbs = 128 * 256; gC = HN; ldc = D_; cbs = 128; gN = 128; gK = 256; gbatch = 16; } }
      else if (step == 8) { type = 1; epi = 2; gB = at ? aoT : coT; gC = h; }
      else if (step == 9) { type = 0; rsrc = h; rg = p.in[2] + L * D_; rmode = 0; }
      else if (step == 10) { type = 1; epi = 1; gB = W1T; gC = BIG; ldc = FF_; gN = FF_; }
      else { type = 1; epi = 2; gA = BIG; lda = FF_; gB = W2T; ldb = FF_; gC = h; gK = FF_; }
      if (type == 5) continue;
      if (type == 0) {
        rms_phase(rsrc, rg, HN, h, rmode);
        if (step == 0 && L < 4) {
#pragma unroll 1
          for (int ti = 0; ti < 8; ++ti) {
            const float* ts = nullptr; bf16_t* td = nullptr; int tK = 0, tN = 0, tNp = 0, tb = 1;
            if (ti == 0) { ts = p.in[3] + (long)L * D_ * FF_; td = W1T; tK = D_; tN = FF_; tNp = FF_; }
            else if (ti == 1) { ts = p.in[4] + (long)L * D_ * FF_; td = W2T; tK = FF_; tN = D_; tNp = D_; }
            else if (!at) {
              if (ti == 2) { ts = p.in[5] + (long)j * D_ * 6144; td = inT; tK = D_; tN = 6144; tNp = 6144; }
              else if (ti == 3) { ts = p.in[7] + (long)j * D_ * D_; td = coT; tK = D_; tN = D_; tNp = D_; }
            } else {
              if (ti == 2) { ts = p.in[8] + (long)j * D_ * 848; td = inT; tK = D_; tN = 848; tNp = 896; }
              else if (ti == 3) { ts = p.in[11] + (long)j * 512 * 2048; td = uqT; tK = 512; tN = 2048; tNp = 2048; }
              else if (ti == 4) { ts = p.in[14] + (long)j * 512 * 1024; td = qiT; tK = 512; tN = 1024; tNp = 1024; }
              else if (ti == 5) { ts = p.in[12] + (long)j * 16 * 128 * 256; td = ukT; tK = 128; tN = 256; tNp = 256; tb = 16; }
              else if (ti == 6) { ts = p.in[13] + (long)j * 16 * 256 * 128; td = uvT; tK = 256; tN = 128; tNp = 128; tb = 16; }
              else { ts = p.in[17] + (long)j * D_ * D_; td = aoT; tK = D_; tN = D_; tNp = D_; }
            }
            if (ts != nullptr) transpose_phase(ts, td, tK, tN, tNp, tb, smem);
          }
        }
      } else if (type == 1) {
        gemm_phase(epi, gA, lda, abs_, gB, ldb, bbs, gC, ldc, cbs, gN, gK, gbatch, smem);
      } else if (type == 2) {
        conv_phase(BIG, p.in[6] + (long)j * 3 * D_, HN);
      } else if (type == 3) {
        attn_norm_phase(PROJ, p.in[9] + j * 512, p.in[10] + j * 256, p.in[15] + j * 64, p.in[16] + j * 64, CQ, CKV, KIDX, WIDX);
      } else {
        attn_phase(QIDX, KIDX, WIDX, CKV, BIG, smem);
      }
      if (L < 4) grid_bar(bar, epoch);
    }
  }
}

extern "C" void kernel_launch(void* const* d_in, const int* in_sizes, int n_in,
                              void* d_out, int out_size, void* d_ws, size_t ws_size,
                              hipStream_t stream) {
  Params p{};
  for (int i = 0; i < 19; ++i) p.in[i] = (const float*)d_in[i];
  p.out = (float*)d_out; p.ws = (char*)d_ws;
  hipMemsetAsync(d_ws, 0, 4096, stream);
  int occ = 0;
  hipOccupancyMaxActiveBlocksPerMultiprocessor(&occ, mega_kernel, 256, 0);
  int dev = 0; hipGetDevice(&dev);
  int ncu = 256; hipDeviceGetAttribute(&ncu, hipDeviceAttributeMultiprocessorCount, dev);
  int per = occ < 1 ? 1 : (occ > 2 ? 2 : occ);
  mega_kernel<<<dim3(ncu * per), dim3(256), 0, stream>>>(p);
}
```
